# Optimizing an MI355X kernel written in HIP

```python
import functools
import jax, jax.numpy as jnp
from jax import lax
import numpy as np

D_MODEL = 1024
BATCH = 2
SEQ = 8192
DEPTH = 4
DEC_BATCH = 32
DEC_SEQ = 1
PAST_LEN = 8192
PAGE_SIZE = 128

HEAD_DIM = 64
HEADS_PER_GROUP = 4
GROUPS = ((128, 1), (512, 4), (2048, 16))
N_GROUPS = len(GROUPS)
ATTN_WIDTH = N_GROUPS * HEADS_PER_GROUP * HEAD_DIM
ATTN_OUT_WIDTH = HEADS_PER_GROUP * HEAD_DIM
CONV_CHANNELS = 768
CONV_WIDTH = 3
D_FF = 4 * D_MODEL
PLE_DIM = 256
ROPE_THETA = 10000.0
BLOCK = 128
RMS_EPS = 1e-6
NEG_INF = -1e30
IN_PROJ_WIDTH = 3 * ATTN_WIDTH + 3 * CONV_CHANNELS + 2 * D_MODEL
SPLITS = [ATTN_WIDTH, 2 * ATTN_WIDTH, 3 * ATTN_WIDTH,
          3 * ATTN_WIDTH + CONV_CHANNELS, 3 * ATTN_WIDTH + 2 * CONV_CHANNELS,
          3 * ATTN_WIDTH + 3 * CONV_CHANNELS, 3 * ATTN_WIDTH + 3 * CONV_CHANNELS + D_MODEL]

kernel_name = "dilated_swa_shortconv_gated_hybrid_step"


def rmsnorm(x, g):
    x32 = x.astype(jnp.float32)
    y = x32 * lax.rsqrt(jnp.mean(x32 * x32, axis=-1, keepdims=True) + RMS_EPS) * g.astype(jnp.float32)
    return y.astype(x.dtype)


def rope(x, pos):
    half = HEAD_DIM // 2
    inv = jnp.power(ROPE_THETA, -2.0 * jnp.arange(half, dtype=jnp.float32) / HEAD_DIM)
    ang = pos.astype(jnp.float32)[:, None] * inv[None, :]
    cos = jnp.cos(ang)[:, None, :]
    sin = jnp.sin(ang)[:, None, :]
    x32 = x.astype(jnp.float32)
    x1, x2 = x32[..., :half], x32[..., half:]
    return jnp.concatenate([x1 * cos - x2 * sin, x2 * cos + x1 * sin], axis=-1).astype(x.dtype)


def dilated_group_prompt(q, k, v, window, dil):
    b, s_len, h, dh = q.shape
    n_back = window // dil
    span = dil * BLOCK
    s_pad = -(-s_len // span) * span
    nb = s_pad // span

    def to_blocks(x):
        x = jnp.pad(x, ((0, 0), (0, s_pad - s_len), (0, 0), (0, 0)))
        x = x.reshape(b, s_pad // dil, dil, h, dh).swapaxes(1, 2)
        return x.reshape(b * dil, nb, BLOCK, h, dh)

    def with_prev(x):
        prev = jnp.pad(x, ((0, 0), (1, 0), (0, 0), (0, 0), (0, 0)))[:, :-1]
        return jnp.concatenate([prev, x], axis=2)

    qb = to_blocks(q)
    kc = with_prev(to_blocks(k))
    vc = with_prev(to_blocks(v))
    scores = jnp.einsum('gnqhd,gnkhd->gnhqk', qb, kc).astype(jnp.float32) * (HEAD_DIM ** -0.5)
    qi = jnp.arange(BLOCK)[:, None]
    ki = jnp.arange(2 * BLOCK)[None, :]
    dist = qi + BLOCK - ki
    blk = jnp.arange(nb)[:, None, None]
    valid = (dist >= 0) & (dist <= n_back) & ((blk > 0) | (ki >= BLOCK))
    scores = jnp.where(valid[None, :, None], scores, NEG_INF)
    m = jnp.max(scores, axis=-1)
    p = jnp.exp(scores - m[..., None])
    l = jnp.sum(p, axis=-1)
    o = jnp.einsum('gnhqk,gnkhd->gnqhd', p, vc.astype(jnp.float32)) / l.swapaxes(2, 3)[..., None]

    def from_blocks(x):
        tail = x.shape[3:]
        x = x.reshape(b, dil, s_pad // dil, *tail).swapaxes(1, 2).reshape(b, s_pad, *tail)
        return x[:, :s_len]

    return from_blocks(o), from_blocks(m.swapaxes(2, 3)), from_blocks(l.swapaxes(2, 3))


def dilated_group_sample(q, k_new, v_new, k_buf, v_buf, window, dil):
    t = q.shape[1]
    lb = k_buf.shape[1]
    n_back = window // dil
    kc = jnp.concatenate([k_buf, k_new.astype(k_buf.dtype)], axis=1)
    vc = jnp.concatenate([v_buf, v_new.astype(v_buf.dtype)], axis=1)
    idx = lb + jnp.arange(t)[:, None] - dil * jnp.arange(n_back + 1)[None, :]
    valid = idx >= 0
    idx = jnp.maximum(idx, 0)
    kg = kc[:, idx]
    vg = vc[:, idx]
    scores = jnp.einsum('bthd,btjhd->bhtj', q, kg).astype(jnp.float32) * (HEAD_DIM ** -0.5)
    scores = jnp.where(valid[None, None], scores, NEG_INF)
    m = jnp.max(scores, axis=-1)
    p = jnp.exp(scores - m[..., None])
    l = jnp.sum(p, axis=-1)
    o = jnp.einsum('bhtj,btjhd->bthd', p, vg.astype(jnp.float32)) / l.swapaxes(1, 2)[..., None]
    return o, m.swapaxes(1, 2), l.swapaxes(1, 2), kc[:, -lb:], vc[:, -lb:]


def merge_groups(outs, maxes, denoms, dtype):
    mx = functools.reduce(jnp.maximum, maxes)
    ws = [l * jnp.exp(m - mx) for m, l in zip(maxes, denoms)]
    num = sum(w[..., None] * o for w, o in zip(ws, outs))
    o = num / sum(ws)[..., None]
    return o.reshape(o.shape[0], o.shape[1], ATTN_OUT_WIDTH).astype(dtype)


def attn_prompt(q, k, v):
    outs, maxes, denoms, state = [], [], [], []
    for g, (window, dil) in enumerate(GROUPS):
        sl = slice(g * HEADS_PER_GROUP, (g + 1) * HEADS_PER_GROUP)
        o, m, l = dilated_group_prompt(q[:, :, sl], k[:, :, sl], v[:, :, sl], window, dil)
        outs.append(o); maxes.append(m); denoms.append(l)
        keep = min(window, q.shape[1])
        state += [k[:, -keep:, sl], v[:, -keep:, sl]]
    return merge_groups(outs, maxes, denoms, q.dtype), state


def attn_sample(q, k, v, bufs):
    outs, maxes, denoms, state = [], [], [], []
    for g, (window, dil) in enumerate(GROUPS):
        sl = slice(g * HEADS_PER_GROUP, (g + 1) * HEADS_PER_GROUP)
        o, m, l, nk, nv = dilated_group_sample(q[:, :, sl], k[:, :, sl], v[:, :, sl],
                                               bufs[2 * g], bufs[2 * g + 1], window, dil)
        outs.append(o); maxes.append(m); denoms.append(l)
        state += [nk, nv]
    return merge_groups(outs, maxes, denoms, q.dtype), state


def short_conv(u, prev, conv_w):
    t = u.shape[1]
    uc = jnp.concatenate([prev.astype(u.dtype), u], axis=1)
    y = sum(conv_w[j] * uc[:, j:j + t] for j in range(CONV_WIDTH))
    return y, uc[:, -(CONV_WIDTH - 1):]


def layer(h, ple, pos, attn_fn, conv_prev, w_in, conv_w, w_attn_out, w_conv_out, w_o,
          g_pre_mix, g_post_mix, w_up, w_down, g_pre_mlp, g_post_mlp, g_ple, w_ple_gate, w_ple_proj):
    bt, t, _ = h.shape
    xn = rmsnorm(h, g_pre_mix)
    proj = xn @ w_in
    q, k, v, cb, cc, ch, ga, gb = jnp.split(proj, SPLITS, axis=-1)
    nq = N_GROUPS * HEADS_PER_GROUP
    q = rope(q.reshape(bt, t, nq, HEAD_DIM), pos)
    k = rope(k.reshape(bt, t, nq, HEAD_DIM), pos)
    v = v.reshape(bt, t, nq, HEAD_DIM)
    attn, attn_state = attn_fn(q, k, v)
    conv, conv_state = short_conv(cc * ch, conv_prev, conv_w)
    a = attn @ w_attn_out
    c = (cb * conv) @ w_conv_out
    mix = (jax.nn.sigmoid(ga) * a + jax.nn.sigmoid(gb) * c) @ w_o
    h = h + rmsnorm(mix, g_post_mix)
    f = rmsnorm(h, g_pre_mlp) @ w_up
    f = jnp.square(jax.nn.relu(f)) @ w_down
    h = h + rmsnorm(f, g_post_mlp)
    h = h + jax.nn.sigmoid(rmsnorm(h, g_ple) @ w_ple_gate) * (ple @ w_ple_proj)
    return h, attn_state, conv_state


def setup_inputs(seed: int = 0) -> dict:
    key = jax.random.key(seed)
    ks = iter(jax.random.split(key, 40))

    def nrm(shape, scale=1.0):
        return scale * jax.random.normal(next(ks), shape, jnp.float32)

    def gain():
        return 1.0 + nrm((DEPTH, D_MODEL), 0.05)

    inp = {}
    inp['x_prompt'] = nrm((BATCH, SEQ, D_MODEL))
    inp['x_sample'] = nrm((DEC_BATCH, DEC_SEQ, D_MODEL))
    inp['p_prompt'] = nrm((DEPTH, BATCH, SEQ, PLE_DIM))
    inp['p_sample'] = nrm((DEPTH, DEC_BATCH, DEC_SEQ, PLE_DIM))
    for window, _ in GROUPS:
        lb = min(window, PAST_LEN)
        inp['cache_k_w%d' % window] = nrm((DEPTH, DEC_BATCH, lb, HEADS_PER_GROUP, HEAD_DIM))
        inp['cache_v_w%d' % window] = nrm((DEPTH, DEC_BATCH, lb, HEADS_PER_GROUP, HEAD_DIM))
    inp['state_conv'] = nrm((DEPTH, DEC_BATCH, CONV_WIDTH - 1, CONV_CHANNELS))
    inp['w_in'] = nrm((DEPTH, D_MODEL, IN_PROJ_WIDTH), D_MODEL ** -0.5)
    inp['conv_w'] = nrm((DEPTH, CONV_WIDTH, CONV_CHANNELS), CONV_WIDTH ** -0.5)
    inp['w_attn_out'] = nrm((DEPTH, ATTN_OUT_WIDTH, D_MODEL), ATTN_OUT_WIDTH ** -0.5)
    inp['w_conv_out'] = nrm((DEPTH, CONV_CHANNELS, D_MODEL), CONV_CHANNELS ** -0.5)
    inp['w_o'] = nrm((DEPTH, D_MODEL, D_MODEL), D_MODEL ** -0.5)
    inp['g_pre_mix'] = gain()
    inp['g_post_mix'] = gain()
    inp['w_up'] = nrm((DEPTH, D_MODEL, D_FF), D_MODEL ** -0.5)
    inp['w_down'] = nrm((DEPTH, D_FF, D_MODEL), D_FF ** -0.5)
    inp['g_pre_mlp'] = gain()
    inp['g_post_mlp'] = gain()
    inp['g_ple'] = gain()
    inp['w_ple_gate'] = nrm((DEPTH, D_MODEL, D_MODEL), D_MODEL ** -0.5)
    inp['w_ple_proj'] = nrm((DEPTH, PLE_DIM, D_MODEL), PLE_DIM ** -0.5)
    return inp


def reference(x_prompt, x_sample, p_prompt, p_sample,
              cache_k_w128, cache_v_w128, cache_k_w512, cache_v_w512, cache_k_w2048, cache_v_w2048,
              state_conv, w_in, conv_w, w_attn_out, w_conv_out, w_o, g_pre_mix, g_post_mix,
              w_up, w_down, g_pre_mlp, g_post_mlp, g_ple, w_ple_gate, w_ple_proj):
    pos_p = jnp.arange(x_prompt.shape[1], dtype=jnp.int32)
    pos_s = PAST_LEN + jnp.arange(x_sample.shape[1], dtype=jnp.int32)
    conv_zero = jnp.zeros((x_prompt.shape[0], CONV_WIDTH - 1, CONV_CHANNELS), x_prompt.dtype)
    hp, hs = x_prompt, x_sample
    st_p, st_s = [], []
    for i in range(DEPTH):
        lw = (w_in[i], conv_w[i], w_attn_out[i], w_conv_out[i], w_o[i], g_pre_mix[i], g_post_mix[i],
              w_up[i], w_down[i], g_pre_mlp[i], g_post_mlp[i], g_ple[i], w_ple_gate[i], w_ple_proj[i])
        hp, a_p, c_p = layer(hp, p_prompt[i], pos_p, attn_prompt, conv_zero, *lw)
        bufs = (cache_k_w128[i], cache_v_w128[i], cache_k_w512[i], cache_v_w512[i],
                cache_k_w2048[i], cache_v_w2048[i])
        hs, a_s, c_s = layer(hs, p_sample[i], pos_s, functools.partial(attn_sample, bufs=bufs),
                             state_conv[i], *lw)
        st_p.append(a_p + [c_p])
        st_s.append(a_s + [c_s])
    (k128_p, v128_p, k512_p, v512_p, k2048_p, v2048_p, conv_p) = [jnp.stack(col) for col in zip(*st_p)]
    (k128_s, v128_s, k512_s, v512_s, k2048_s, v2048_s, conv_s) = [jnp.stack(col) for col in zip(*st_s)]
    return (hp, hs, k128_p, v128_p, k512_p, v512_p, k2048_p, v2048_p, conv_p,
            k128_s, v128_s, k512_s, v512_s, k2048_s, v2048_s, conv_s)
```

```cpp
#include <hip/hip_runtime.h>
#include <cstdio>
#include <cstdint>

#ifndef PH_MASK
#define PH_MASK 0xFFFFF
#endif
#define PH_ON(k) (((PH_MASK) >> (k)) & 1)
#ifndef MK_ONE_LAUNCH
#define MK_ONE_LAUNCH 1
#endif

constexpr int NWAVES = 8;
constexpr int DM = 1024, SEQ = 8192, NB = 2, M = NB * SEQ, NS = 32, MP = M + NS, MPAD = 16640, DEPTH = 4, FF = 4096, NPROJ = 6656, PLE = 256, AW = 768;
constexpr float RMS_EPS = 1e-6f;
constexpr int NPH_LAYER = 13, NPHASES = 1 + DEPTH * NPH_LAYER;

constexpr size_t O_YP = 0, O_YS = (size_t)M * DM;
constexpr size_t O_K128P = O_YS + (size_t)NS * DM, O_V128P = O_K128P + (size_t)DEPTH * NB * 128 * 256, O_K512P = O_V128P + (size_t)DEPTH * NB * 128 * 256, O_V512P = O_K512P + (size_t)DEPTH * NB * 512 * 256,
                 O_K2048P = O_V512P + (size_t)DEPTH * NB * 512 * 256, O_V2048P = O_K2048P + (size_t)DEPTH * NB * 2048 * 256, O_CONVP = O_V2048P + (size_t)DEPTH * NB * 2048 * 256;
constexpr size_t O_K128S = O_CONVP + (size_t)DEPTH * NB * 2 * AW, O_V128S = O_K128S + (size_t)DEPTH * NS * 128 * 256, O_K512S = O_V128S + (size_t)DEPTH * NS * 128 * 256, O_V512S = O_K512S + (size_t)DEPTH * NS * 512 * 256,
                 O_K2048S = O_V512S + (size_t)DEPTH * NS * 512 * 256, O_V2048S = O_K2048S + (size_t)DEPTH * NS * 2048 * 256, O_CONVS = O_V2048S + (size_t)DEPTH * NS * 2048 * 256, O_END = O_CONVS + (size_t)DEPTH * NS * 2 * AW;
static_assert(O_END == 204189696ull, "output size");

constexpr size_t MiB = 1u << 20;
constexpr size_t WS_CTL = 0, CTL_ZERO_BYTES = 1 * MiB;
constexpr size_t WS_ROPE = 1 * MiB;
constexpr size_t WS_W = 4 * MiB, W_LAYER = 36 * MiB;
constexpr size_t W_IN = 0, W_CAT = 13 * MiB, W_O = 15 * MiB, W_UP = 17 * MiB, W_DN = 25 * MiB, W_G = 33 * MiB, W_PP = 35 * MiB;
constexpr size_t WS_XN = WS_W + DEPTH * W_LAYER;
constexpr size_t WS_Q = WS_XN + 33 * MiB, WS_K = WS_Q + 24 * MiB, WS_V = WS_K + 24 * MiB, WS_CB = WS_V + 24 * MiB, WS_U = WS_CB + 24 * MiB, WS_OG = WS_U + 24 * MiB;
constexpr size_t WS_SGA = WS_OG + 24 * MiB, WS_SGB = WS_SGA + 32 * MiB;
constexpr size_t WS_ML = WS_SGB + 32 * MiB;
constexpr size_t WS_ACAT = WS_ML + 2 * MiB, WS_UG = WS_ACAT + 33 * MiB;
constexpr size_t WS_F = WS_UG + 33 * MiB;
constexpr size_t WS_T1 = WS_F + 132 * MiB;
constexpr size_t WS_PLE = WS_T1 + 66 * MiB, PLE_LAYER = (size_t)MPAD * PLE * 2;
constexpr size_t WS_PS = WS_PLE + 34 * MiB;
constexpr size_t WS_END = WS_PS + 1 * MiB;
static_assert((size_t)NPROJ * DM * 2 == 13 * MiB && 4 * PLE_LAYER <= 34 * MiB && (size_t)MPAD * DM * 2 <= 33 * MiB && (size_t)MPAD * FF * 2 <= 132 * MiB && (size_t)MPAD * DM * 4 <= 66 * MiB, "ws map");
constexpr int CW_BAR = 4096;

constexpr int RING_OFF = 0, RING_BYTES = 131072;
constexpr int LDSCTL_OFF = RING_BYTES, MISC_OFF = LDSCTL_OFF + 320;
constexpr int LDS_BYTES = 147456;

namespace pg8 {
#define PG8_LAS __attribute__((address_space(3)))
typedef unsigned short bf16_t;
typedef short bf16x8 __attribute__((ext_vector_type(8)));
typedef float f32x4 __attribute__((ext_vector_type(4)));
typedef float f32x2 __attribute__((ext_vector_type(2)));
typedef unsigned u32x4 __attribute__((ext_vector_type(4)));
typedef unsigned u32x2 __attribute__((ext_vector_type(2)));
constexpr int BM = 256, BK = 64, HALF = 128, HTB = HALF * BK * 2  , STAGE_BYTES = 8 * HTB, NXCD = 8, WGM = 8;

__host__ __device__ __forceinline__ int lds_byte(int r, int c) { const int st = (r >> 4) * 2 + (c >> 5), rr = r & 15, cc = c & 31, ob = rr * 64 + cc * 2; return st * 1024 + (ob ^ (((ob >> 9) & 1) << 5)); }
__host__ __device__ __forceinline__ void stage_rc(int b, int& R, int& C) { const int st = b / 1024, sb = b % 1024, swz = sb ^ (((sb >> 9) & 1) << 5); R = (st >> 1) * 16 + swz / 64; C = (st & 1) * 32 + (swz % 64) / 2; }
__host__ __device__ __forceinline__ int perm32(int rho) { const int n = rho >> 4, i = rho & 15; return 8 * (i >> 2) + 4 * n + (i & 3); }

struct Unit { int pm, pn; };
struct Gemm { const bf16_t* A; const bf16_t* Bt; int M, N, K, lda, ldb; };

struct StaticOrder {
    int nM, nN, nwg, G, c;
    __host__ __device__ void init(int M, int N, int G_, int c_) { nM = M / BM; nN = N / BM; nwg = nM * nN; G = G_; c = c_; }
    __host__ __device__ bool next(int i, Unit& u) const {
        const long L = (long)i * G + c; if (L >= nwg) return false;
        int wgid = (int)L; { const int q = nwg / NXCD, r = nwg % NXCD, xcd = wgid % NXCD, off = wgid / NXCD; wgid = (xcd < r ? xcd * (q + 1) : r * (q + 1) + (xcd - r) * q) + off; }
        const int nig = WGM * nN, gid = wgid / nig, fm = gid * WGM, gsz = (nM - fm) < WGM ? (nM - fm) : WGM;
        u.pm = fm + ((wgid % nig) % gsz); u.pn = (wgid % nig) / gsz; return true;
    }
    __device__ __forceinline__ void a_ready(const Unit&) const {}
    __device__ __forceinline__ void done(const Unit&) const {}
};

typedef __bf16 bf16x2_t __attribute__((ext_vector_type(2)));
__device__ __forceinline__ unsigned cvt_pk_bf16(float lo, float hi) { f32x2 v = {lo, hi}; bf16x2_t r = __builtin_convertvector(v, bf16x2_t); return __builtin_bit_cast(unsigned, r); }
__device__ __forceinline__ float sigmoidf_fast(float x) { return __builtin_amdgcn_rcpf(1.0f + __builtin_amdgcn_exp2f(-1.4426950408889634f * x)); }
__device__ __forceinline__ float bf2f(unsigned short v) { return __uint_as_float((unsigned)v << 16); }
__device__ __forceinline__ u32x4 pack8(const f32x4 a, const f32x4 b) { u32x4 w; w.x = cvt_pk_bf16(a[0], a[1]); w.y = cvt_pk_bf16(a[2], a[3]); w.z = cvt_pk_bf16(b[0], b[1]); w.w = cvt_pk_bf16(b[2], b[3]); return w; }
__device__ __forceinline__ void unpack8(const u32x4 w, f32x4& a, f32x4& b) {
    a[0] = __uint_as_float(w.x << 16); a[1] = __uint_as_float(w.x & 0xffff0000u); a[2] = __uint_as_float(w.y << 16); a[3] = __uint_as_float(w.y & 0xffff0000u);
    b[0] = __uint_as_float(w.z << 16); b[1] = __uint_as_float(w.z & 0xffff0000u); b[2] = __uint_as_float(w.w << 16); b[3] = __uint_as_float(w.w & 0xffff0000u); }

constexpr int SEQ_T = 8192;
constexpr float QSCALE = 0.125f * 1.4426950408889634f;

struct EpiInProj {
    static constexpr bool PERM = true, AFTER_DRAIN = false;
    unsigned char* ws; float* out; int layer;
    __device__ __forceinline__ void operator()(const f32x4 (&acc)[2][2][4][2], const Unit& u, int wr, int wc, int fr_in, int fq) const {
        int fr = fr_in; asm volatile("" : "+v"(fr));
        const int pn = u.pn, row0 = u.pm * BM + wr * 64 + fr, cl = wc * 32 + 8 * fq;
        if (pn < 6) {
            const bool isk = pn >= 3; const int g = isk ? pn - 3 : pn; bf16_t* dst = (bf16_t*)(ws + (isk ? WS_K : WS_Q)); const float sc = isk ? 1.0f : QSCALE;
            const int W = 128 << (2 * g); float* ok = out + (g == 0 ? O_K128P : (g == 1 ? O_K512P : O_K2048P)) + (size_t)layer * 2 * W * 256;
#pragma unroll
            for (int ai = 0; ai < 2; ++ai)
#pragma unroll
                for (int m = 0; m < 4; ++m) {
                    const int row = row0 + ai * HALF + m * 16, t = row & (SEQ_T - 1), b = row >> 13;
                    const f32x4* cs = (const f32x4*)((const float*)(ws + WS_ROPE) + (size_t)t * 64 + 16 * fq);
                    const f32x4 c0 = cs[0], c1 = cs[1], c2 = cs[2], c3 = cs[3];
                    const f32x4 x1a = acc[ai][0][m][0], x1b = acc[ai][0][m][1], x2a = acc[ai][1][m][0], x2b = acc[ai][1][m][1];
                    f32x4 o1a, o1b, o2a, o2b;
                    o1a[0] = x1a[0] * c0[0] - x2a[0] * c0[1]; o2a[0] = x2a[0] * c0[0] + x1a[0] * c0[1];
                    o1a[1] = x1a[1] * c0[2] - x2a[1] * c0[3]; o2a[1] = x2a[1] * c0[2] + x1a[1] * c0[3];
                    o1a[2] = x1a[2] * c1[0] - x2a[2] * c1[1]; o2a[2] = x2a[2] * c1[0] + x1a[2] * c1[1];
                    o1a[3] = x1a[3] * c1[2] - x2a[3] * c1[3]; o2a[3] = x2a[3] * c1[2] + x1a[3] * c1[3];
                    o1b[0] = x1b[0] * c2[0] - x2b[0] * c2[1]; o2b[0] = x2b[0] * c2[0] + x1b[0] * c2[1];
                    o1b[1] = x1b[1] * c2[2] - x2b[1] * c2[3]; o2b[1] = x2b[1] * c2[2] + x1b[1] * c2[3];
                    o1b[2] = x1b[2] * c3[0] - x2b[2] * c3[1]; o2b[2] = x2b[2] * c3[0] + x1b[2] * c3[1];
                    o1b[3] = x1b[3] * c3[2] - x2b[3] * c3[3]; o2b[3] = x2b[3] * c3[2] + x1b[3] * c3[3];
                    if (isk && t >= SEQ_T - W) {
                        float* o = ok + ((size_t)(b * W + (t - (SEQ_T - W))) * 256 + wc * 64 + 8 * fq);
                        *(f32x4*)(o) = o1a; *(f32x4*)(o + 4) = o1b; *(f32x4*)(o + 32) = o2a; *(f32x4*)(o + 36) = o2b;
                    }
                    bf16_t* p = dst + (size_t)row * 768 + g * 256 + wc * 64 + 8 * fq;
                    *(u32x4*)(p) = pack8(o1a * sc, o1b * sc); *(u32x4*)(p + 32) = pack8(o2a * sc, o2b * sc);
                    asm volatile("" ::: "memory");
                }
        } else if (pn < 12) {
            const bool isv = pn < 9; const int g = isv ? pn - 6 : pn - 9; bf16_t* dst = (bf16_t*)(ws + (isv ? WS_V : WS_CB));
            const int W = 128 << (2 * g); float* ov = out + (g == 0 ? O_V128P : (g == 1 ? O_V512P : O_V2048P)) + (size_t)layer * 2 * W * 256;
#pragma unroll
            for (int ai = 0; ai < 2; ++ai)
#pragma unroll
                for (int m = 0; m < 4; ++m) {
                    const int row = row0 + ai * HALF + m * 16, t = row & (SEQ_T - 1), b = row >> 13;
                    bf16_t* p = dst + (size_t)row * 768 + g * 256 + cl;
#pragma unroll
                    for (int bj = 0; bj < 2; ++bj) *(u32x4*)(p + bj * HALF) = pack8(acc[ai][bj][m][0], acc[ai][bj][m][1]);
                    if (isv && t >= SEQ_T - W) {
                        float* o = ov + ((size_t)(b * W + (t - (SEQ_T - W))) * 256 + cl);
#pragma unroll
                        for (int bj = 0; bj < 2; ++bj) { *(f32x4*)(o + bj * HALF) = acc[ai][bj][m][0]; *(f32x4*)(o + bj * HALF + 4) = acc[ai][bj][m][1]; }
                    }
                }
        } else if (pn < 18) {
            const int j = pn - 12;
#pragma unroll
            for (int ai = 0; ai < 2; ++ai)
#pragma unroll
                for (int m = 0; m < 4; ++m) {
                    const int row = row0 + ai * HALF + m * 16, t = row & (SEQ_T - 1), b = row >> 13;
                    const f32x4 ua = acc[ai][0][m][0] * acc[ai][1][m][0], ub = acc[ai][0][m][1] * acc[ai][1][m][1];
                    *(u32x4*)((bf16_t*)(ws + WS_U) + (size_t)row * 768 + j * 128 + cl) = pack8(ua, ub);
                    if (t >= SEQ_T - 2) { float* o = out + O_CONVP + (size_t)layer * 2 * 2 * 768 + (size_t)(b * 2 + (t - (SEQ_T - 2))) * 768 + j * 128 + cl; *(f32x4*)o = ua; *(f32x4*)(o + 4) = ub; }
                }
        } else {
            const bool isa = pn < 22; const int tcol = (isa ? pn - 18 : pn - 22) * 256; bf16_t* dst = (bf16_t*)(ws + (isa ? WS_SGA : WS_SGB));
#pragma unroll
            for (int ai = 0; ai < 2; ++ai)
#pragma unroll
                for (int m = 0; m < 4; ++m) {
                    const int row = row0 + ai * HALF + m * 16; bf16_t* p = dst + (size_t)row * 1024 + tcol + cl;
#pragma unroll
                    for (int bj = 0; bj < 2; ++bj) { f32x4 a = acc[ai][bj][m][0], c = acc[ai][bj][m][1];
#pragma unroll
                        for (int i = 0; i < 4; ++i) { a[i] = sigmoidf_fast(a[i]); c[i] = sigmoidf_fast(c[i]); }
                        *(u32x4*)(p + bj * HALF) = pack8(a, c); }
                }
        }
    }
};

struct EpiF32 {
    static constexpr bool PERM = false, AFTER_DRAIN = false;
    float* C; int ldc;
    __device__ __forceinline__ void operator()(const f32x4 (&acc)[2][2][4][2], const Unit& u, int wr, int wc, int fr_in, int fq) const {
        int fr = fr_in; asm volatile("" : "+v"(fr));
        const int row0 = u.pm * BM + wr * 64 + fr, col0 = u.pn * BM + wc * 32 + 4 * fq;
#pragma unroll
        for (int ai = 0; ai < 2; ++ai)
#pragma unroll
            for (int m = 0; m < 4; ++m) { float* rowp = C + (size_t)(row0 + ai * HALF + m * 16) * ldc + col0;
#pragma unroll
                for (int bj = 0; bj < 2; ++bj)
#pragma unroll
                    for (int n = 0; n < 2; ++n) *(f32x4*)(rowp + bj * HALF + n * 16) = acc[ai][bj][m][n]; }
    }
};

struct EpiGateMix {
    static constexpr bool PERM = true, AFTER_DRAIN = false;
    const float* T1; const bf16_t* SGA; const bf16_t* SGB; bf16_t* UG;
    __device__ __forceinline__ void operator()(const f32x4 (&acc)[2][2][4][2], const Unit& u, int wr, int wc, int fr_in, int fq) const {
        int fr = fr_in; asm volatile("" : "+v"(fr));
        const int row0 = u.pm * BM + wr * 64 + fr, col0 = u.pn * BM + wc * 32 + 8 * fq;
#pragma unroll
        for (int ai = 0; ai < 2; ++ai)
#pragma unroll
            for (int m = 0; m < 4; ++m) { const size_t off = (size_t)(row0 + ai * HALF + m * 16) * 1024 + col0;
#pragma unroll
                for (int bj = 0; bj < 2; ++bj) {
                    const f32x4 a0 = *(const f32x4*)(T1 + off + bj * HALF), a1 = *(const f32x4*)(T1 + off + bj * HALF + 4);
                    f32x4 ga0, ga1, gb0, gb1; unpack8(*(const u32x4*)(SGA + off + bj * HALF), ga0, ga1); unpack8(*(const u32x4*)(SGB + off + bj * HALF), gb0, gb1);
                    const f32x4 o0 = ga0 * a0 + gb0 * acc[ai][bj][m][0], o1 = ga1 * a1 + gb1 * acc[ai][bj][m][1];
                    *(u32x4*)(UG + off + bj * HALF) = pack8(o0, o1); }
                asm volatile("" ::: "memory"); }
    }
};

struct EpiRelu2 {
    static constexpr bool PERM = true, AFTER_DRAIN = false;
    bf16_t* O; int ldc;
    __device__ __forceinline__ void operator()(const f32x4 (&acc)[2][2][4][2], const Unit& u, int wr, int wc, int fr_in, int fq) const {
        int fr = fr_in; asm volatile("" : "+v"(fr));
        const int row0 = u.pm * BM + wr * 64 + fr, col0 = u.pn * BM + wc * 32 + 8 * fq;
#pragma unroll
        for (int ai = 0; ai < 2; ++ai)
#pragma unroll
            for (int m = 0; m < 4; ++m) { bf16_t* rowp = O + (size_t)(row0 + ai * HALF + m * 16) * ldc + col0;
#pragma unroll
                for (int bj = 0; bj < 2; ++bj) { f32x4 v0 = acc[ai][bj][m][0], v1 = acc[ai][bj][m][1];
#pragma unroll
                    for (int i = 0; i < 4; ++i) { const float a = fmaxf(v0[i], 0.f), c = fmaxf(v1[i], 0.f); v0[i] = a * a; v1[i] = c * c; }
                    *(u32x4*)(rowp + bj * HALF) = pack8(v0, v1); } }
    }
};

struct EpiPleGate {
    static constexpr bool PERM = false, AFTER_DRAIN = false;
    float* H; const float* T1;
    __device__ __forceinline__ void operator()(const f32x4 (&acc)[2][2][4][2], const Unit& u, int wr, int wc, int fr_in, int fq) const {
        int fr = fr_in; asm volatile("" : "+v"(fr));
        const int row0 = u.pm * BM + wr * 64 + fr, col0 = u.pn * BM + wc * 32 + 4 * fq;
#pragma unroll
        for (int ai = 0; ai < 2; ++ai)
#pragma unroll
            for (int m = 0; m < 4; ++m) { const size_t off = (size_t)(row0 + ai * HALF + m * 16) * 1024 + col0;
#pragma unroll
                for (int bj = 0; bj < 2; ++bj)
#pragma unroll
                    for (int n = 0; n < 2; ++n) { const size_t o = off + bj * HALF + n * 16; const f32x4 pp = *(const f32x4*)(T1 + o), hv = *(const f32x4*)(H + o); f32x4 g = acc[ai][bj][m][n];
#pragma unroll
                        for (int i = 0; i < 4; ++i) g[i] = sigmoidf_fast(g[i]);
                        *(f32x4*)(H + o) = hv + g * pp; }
                asm volatile("" ::: "memory"); }
    }
};

template <class Epi, class Sched, bool ALIGN_EPI = false, bool SP2 = false>
__device__ __forceinline__ void gemm_phase(PG8_LAS unsigned char* lds, const Gemm g, const Sched& S, const Epi& E) {
    int tid_ = threadIdx.x; asm volatile("" : "+v"(tid_));
    const int tid = tid_, wid = __builtin_amdgcn_readfirstlane(tid >> 6), lane = tid & 63, wr = wid >> 2, wc = wid & 3, fr = lane & 15, fq = lane >> 4;
    const int K = g.K, nt = K / BK;
    unsigned voffA[2], voffB[2];
#pragma unroll
    for (int i = 0; i < 2; ++i) { int R, C; stage_rc(tid * 16 + i * 8192, R, C); const int Rb = Epi::PERM ? ((R & ~31) + perm32(R & 31)) : R;
        voffA[i] = (unsigned)(R * g.lda + C) * 2u; voffB[i] = (unsigned)(Rb * g.ldb + C) * 2u; }
    const size_t kstep = (size_t)(BK * 2);
    const size_t hstepA = (size_t)HALF * g.lda * 2, hstepB = (size_t)HALF * g.ldb * 2;
    const size_t tstepA = 2 * hstepA, tstepB = 2 * hstepB;
    const unsigned ldsw = (unsigned)wid * 1024u;
    const int aoff = lds_byte(wr * 64 + fr, fq * 8), boff = lds_byte(wc * 32 + fr, fq * 8);
#define PG8_SA(b, h) (((b) * 2 + (h)) * HTB)
#define PG8_SB(b, h) ((4 + (b) * 2 + (h)) * HTB)
#define PG8_STAGE(bufoff, gbase, voff) do { _Pragma("unroll") for (int _i = 0; _i < 2; ++_i) \
        __builtin_amdgcn_global_load_lds((const unsigned*)((const char*)(gbase) + (voff)[_i]), (PG8_LAS unsigned*)(lds + (bufoff) + ldsw + _i * 8192), 16, 0, 0); } while (0)
#define PG8_LDA(dst, b, h) do { _Pragma("unroll") for (int m = 0; m < 4; ++m) _Pragma("unroll") for (int k = 0; k < 2; ++k) dst[m][k] = *(const PG8_LAS bf16x8*)(lds + PG8_SA(b, h) + aoff + m * 2048 + k * 1024); } while (0)
#define PG8_LDB(dst, b, h) do { _Pragma("unroll") for (int n = 0; n < 2; ++n) _Pragma("unroll") for (int k = 0; k < 2; ++k) dst[n][k] = *(const PG8_LAS bf16x8*)(lds + PG8_SB(b, h) + boff + n * 2048 + k * 1024); } while (0)
#define PG8_MMA(ai, bj, At, Bt) do { __builtin_amdgcn_s_setprio(1); _Pragma("unroll") for (int m = 0; m < 4; ++m) _Pragma("unroll") for (int n = 0; n < 2; ++n) _Pragma("unroll") for (int k = 0; k < 2; ++k) \
        acc[ai][bj][m][n] = __builtin_amdgcn_mfma_f32_16x16x32_bf16(Bt[n][k], At[m][k], acc[ai][bj][m][n], 0, 0, 0); __builtin_amdgcn_s_setprio(0); } while (0)
#define PG8_WAIT_V(n) asm volatile("s_waitcnt vmcnt(" #n ")" ::: "memory")
#define PG8_WAIT_L(n) asm volatile("s_waitcnt lgkmcnt(" #n ")" ::: "memory")
#define PG8_BAR __builtin_amdgcn_s_barrier()
#define PG8_SCHED __builtin_amdgcn_sched_barrier(0)
    Unit cur, nxt; int ui = 0;
    if (!S.next(0, cur)) return;
    f32x4 acc[2][2][4][2];
#pragma unroll
    for (int a = 0; a < 2; ++a)
#pragma unroll
        for (int b = 0; b < 2; ++b)
#pragma unroll
            for (int m = 0; m < 4; ++m)
#pragma unroll
                for (int n = 0; n < 2; ++n) acc[a][b][m][n] = (f32x4){0.f, 0.f, 0.f, 0.f};
    bf16x8 At[4][2], B0[2][2], B1[2][2];
    const char* cA = (const char*)g.A + (size_t)cur.pm * tstepA; const char* cB = (const char*)g.Bt + (size_t)cur.pn * tstepB;
    S.a_ready(cur);
    if constexpr (SP2) {
        PG8_STAGE(PG8_SB(0, 0), cB, voffB); PG8_STAGE(PG8_SB(0, 1), cB + hstepB, voffB); PG8_STAGE(PG8_SA(0, 0), cA, voffA); PG8_STAGE(PG8_SA(0, 1), cA + hstepA, voffA);
        if (wr == 1) PG8_BAR;
        PG8_WAIT_V(2); PG8_BAR;
        PG8_STAGE(PG8_SB(1, 0), cB + kstep, voffB); PG8_STAGE(PG8_SA(1, 0), cA + kstep, voffA); PG8_STAGE(PG8_SB(1, 1), cB + hstepB + kstep, voffB);
        PG8_WAIT_V(6); PG8_BAR;
    } else {
        PG8_STAGE(PG8_SB(0, 0), cB, voffB); PG8_STAGE(PG8_SA(0, 0), cA, voffA); PG8_STAGE(PG8_SB(0, 1), cB + hstepB, voffB); PG8_STAGE(PG8_SA(0, 1), cA + hstepA, voffA);
        if (wr == 1) PG8_BAR;
        PG8_WAIT_V(4); PG8_BAR;
        PG8_STAGE(PG8_SB(1, 0), cB + kstep, voffB); PG8_STAGE(PG8_SA(1, 0), cA + kstep, voffA); PG8_STAGE(PG8_SB(1, 1), cB + hstepB + kstep, voffB);
        PG8_WAIT_V(6); PG8_BAR;
    }
    for (;;) {
        const bool has_next = S.next(ui + 1, nxt);
        const char* nA = has_next ? (const char*)g.A + (size_t)nxt.pm * tstepA : cA; const char* nB = has_next ? (const char*)g.Bt + (size_t)nxt.pn * tstepB : cB;
        for (int t = 0; t < nt; t += 2) {
            const bool last = (t == nt - 2);
            const char* a1 = cA + (size_t)(t + 1) * kstep;
            const char* a2 = last ? nA : cA + (size_t)(t + 2) * kstep; const char* b2 = last ? nB : cB + (size_t)(t + 2) * kstep;
            const char* a3 = a2 + kstep; const char* b3 = b2 + kstep;
            if (last && has_next) S.a_ready(nxt);
            if constexpr (SP2) {
            PG8_LDB(B0, 0, 0); PG8_LDB(B1, 0, 1); PG8_SCHED; PG8_LDA(At, 0, 0); PG8_STAGE(PG8_SA(1, 1), a1 + hstepA, voffA);
            PG8_WAIT_V(8); PG8_WAIT_L(0); PG8_BAR; PG8_MMA(0, 0, At, B0); PG8_MMA(0, 1, At, B1); PG8_BAR; PG8_SCHED;
            PG8_LDA(At, 0, 1); PG8_STAGE(PG8_SB(0, 0), b2, voffB); PG8_STAGE(PG8_SB(0, 1), b2 + hstepB, voffB); PG8_STAGE(PG8_SA(0, 0), a2, voffA);
            PG8_WAIT_V(8); PG8_WAIT_L(0); PG8_BAR; PG8_MMA(1, 0, At, B0); PG8_MMA(1, 1, At, B1); PG8_BAR; PG8_SCHED;
            PG8_LDB(B0, 1, 0); PG8_LDB(B1, 1, 1); PG8_SCHED; PG8_LDA(At, 1, 0); PG8_STAGE(PG8_SA(0, 1), a2 + hstepA, voffA);
            PG8_WAIT_V(8); PG8_WAIT_L(0); PG8_BAR; PG8_MMA(0, 0, At, B0); PG8_MMA(0, 1, At, B1); PG8_BAR; PG8_SCHED;
            PG8_LDA(At, 1, 1); PG8_STAGE(PG8_SB(1, 0), b3, voffB); PG8_STAGE(PG8_SB(1, 1), b3 + hstepB, voffB); PG8_STAGE(PG8_SA(1, 0), a3, voffA);
            PG8_WAIT_V(8); PG8_WAIT_L(0); PG8_BAR; PG8_MMA(1, 0, At, B0); PG8_MMA(1, 1, At, B1); PG8_BAR; PG8_SCHED;
            } else {
            PG8_LDB(B0, 0, 0); PG8_SCHED; PG8_LDA(At, 0, 0); PG8_STAGE(PG8_SA(1, 1), a1 + hstepA, voffA);
            PG8_WAIT_L(8); PG8_BAR; PG8_WAIT_L(0); PG8_MMA(0, 0, At, B0); PG8_BAR; PG8_SCHED;
            PG8_LDB(B1, 0, 1); PG8_STAGE(PG8_SB(0, 0), b2, voffB);
            PG8_BAR; PG8_WAIT_L(0); PG8_MMA(0, 1, At, B1); PG8_BAR;
            PG8_LDA(At, 0, 1); PG8_STAGE(PG8_SA(0, 0), a2, voffA);
            PG8_BAR; PG8_WAIT_L(0); PG8_MMA(1, 0, At, B0); PG8_BAR; PG8_SCHED;
            PG8_STAGE(PG8_SB(0, 1), b2 + hstepB, voffB);
            PG8_WAIT_V(6); PG8_BAR; PG8_MMA(1, 1, At, B1); PG8_BAR;
            PG8_LDB(B0, 1, 0); PG8_SCHED; PG8_LDA(At, 1, 0); PG8_STAGE(PG8_SA(0, 1), a2 + hstepA, voffA);
            PG8_WAIT_L(8); PG8_BAR; PG8_WAIT_L(0); PG8_MMA(0, 0, At, B0); PG8_BAR; PG8_SCHED;
            PG8_LDB(B1, 1, 1); PG8_STAGE(PG8_SB(1, 0), b3, voffB);
            PG8_BAR; PG8_WAIT_L(0); PG8_MMA(0, 1, At, B1); PG8_BAR;
            PG8_LDA(At, 1, 1); PG8_STAGE(PG8_SA(1, 0), a3, voffA);
            PG8_BAR; PG8_WAIT_L(0); PG8_MMA(1, 0, At, B0); PG8_BAR; PG8_SCHED;
            PG8_STAGE(PG8_SB(1, 1), b3 + hstepB, voffB);
            PG8_WAIT_V(6); PG8_BAR; PG8_MMA(1, 1, At, B1); PG8_BAR;
            }
        }
        if constexpr (ALIGN_EPI) { if (wr == 0) PG8_BAR; }
        if constexpr (!Epi::AFTER_DRAIN) { E(acc, cur, wr, wc, fr, fq); S.done(cur); }
        if (!has_next) break;
#pragma unroll
        for (int a = 0; a < 2; ++a)
#pragma unroll
            for (int b = 0; b < 2; ++b)
#pragma unroll
                for (int m = 0; m < 4; ++m)
#pragma unroll
                    for (int n = 0; n < 2; ++n) acc[a][b][m][n] = (f32x4){0.f, 0.f, 0.f, 0.f};
        cur = nxt; cA = nA; cB = nB; ++ui;
        if constexpr (ALIGN_EPI) { if (wr == 1) PG8_BAR; }
    }
    PG8_WAIT_V(0);
    if constexpr (!ALIGN_EPI) { if (wr == 0) PG8_BAR; }
    PG8_BAR;
    if constexpr (Epi::AFTER_DRAIN) { E.fused(acc, cur, wr, wc, fr, fq, lds, wid, lane); S.done(cur); }
#undef PG8_SA
#undef PG8_SB
#undef PG8_STAGE
#undef PG8_LDA
#undef PG8_LDB
#undef PG8_MMA
#undef PG8_WAIT_V
#undef PG8_WAIT_L
#undef PG8_BAR
#undef PG8_SCHED
}
}

#define GAS __attribute__((address_space(1)))
#define LAS __attribute__((address_space(3)))
typedef unsigned short bf16;
typedef unsigned v4u __attribute__((ext_vector_type(4)));
typedef unsigned v2u __attribute__((ext_vector_type(2)));
typedef float f32x4 __attribute__((ext_vector_type(4)));
typedef float f32x2 __attribute__((ext_vector_type(2)));
typedef float f32x16 __attribute__((ext_vector_type(16)));
typedef short bf16x8 __attribute__((ext_vector_type(8)));
typedef short s16x4 __attribute__((ext_vector_type(4)));
typedef GAS unsigned gu32;
#define RLX_AGENT __ATOMIC_RELAXED, __HIP_MEMORY_SCOPE_AGENT
#define LDS_WAIT() asm volatile("s_waitcnt lgkmcnt(0)" ::: "memory")
#define VM_WAIT() asm volatile("s_waitcnt vmcnt(0)" ::: "memory")
#define MFMA32(a, b, c) __builtin_amdgcn_mfma_f32_32x32x16_bf16((a), (b), (c), 0, 0, 0)
using pg8::cvt_pk_bf16; using pg8::bf2f; using pg8::sigmoidf_fast;
__device__ __forceinline__ int crow(int r, int hi) { return (r & 3) + 8 * (r >> 2) + 4 * hi; }

#define XB_TMO      128
#define XB_XCNT(j)  (256  + 64 * (j))
#define XB_XSUB(j)  (1280 + 64 * (j))
#define XB_XGEN(j)  (2304 + 64 * (j))
#define XB_TOP      3328
#define XB_TOPGEN   3392
#define XCD_BAR_WORDS 3456
#define XB_SPIN_CAP (1u << 18)

__device__ __forceinline__ unsigned xb_ld(unsigned* p)              { return __hip_atomic_load(p, __ATOMIC_RELAXED, __HIP_MEMORY_SCOPE_AGENT); }
__device__ __forceinline__ unsigned xb_add(unsigned* p, unsigned v) { return __hip_atomic_fetch_add(p, v, __ATOMIC_RELAXED, __HIP_MEMORY_SCOPE_AGENT); }
__device__ __forceinline__ unsigned xb_xcc_id() { return (unsigned)__builtin_amdgcn_s_getreg((3 << 11) | 20) & 0xFu; }
#define XB_SPIN(cond, bar) do { unsigned _sp = 0; while (cond) { __builtin_amdgcn_s_sleep(1); \
    if ((++_sp & 255u) == 0u) { if (xb_ld(&(bar)[XB_TMO])) break; if (_sp > XB_SPIN_CAP) { atomicAdd(&(bar)[XB_TMO], 1u); break; } } } } while (0)

struct XcdBarrier {
    unsigned* bar; unsigned x;
    volatile LAS unsigned* st;
};

__device__ __forceinline__ XcdBarrier xcd_barrier_post(unsigned* bar, volatile LAS unsigned* st) {
    XcdBarrier b; b.bar = bar; b.x = xb_xcc_id(); b.st = st;
    if (threadIdx.x == 0) (void)xb_add(&bar[XB_XCNT(b.x)], 1u);
    return b;
}
__device__ __forceinline__ void xcd_barrier_complete(unsigned* bar, unsigned x, unsigned& nloc, unsigned& nx) {
    const unsigned G = gridDim.x * gridDim.y * gridDim.z;
    unsigned sum, cnt, mine, sp = 0u;
    for (;;) {
        sum = 0u; cnt = 0u; mine = 0u;
#pragma unroll
        for (unsigned j = 0; j < 16; ++j) { const unsigned c = xb_ld(&bar[XB_XCNT(j)]); sum += c; cnt += (c > 0u) ? 1u : 0u; mine = (j == x) ? c : mine; }
        if (sum == G) break;
        __builtin_amdgcn_s_sleep(1);
        if ((++sp & 255u) == 0u) { if (xb_ld(&bar[XB_TMO])) break; if (sp > XB_SPIN_CAP) { atomicAdd(&bar[XB_TMO], 1u); break; } }
    }
    nloc = mine > 0u ? mine : 1u; nx = cnt > 0u ? cnt : 1u;
}

__device__ __forceinline__ void xcd_barrier(const XcdBarrier& b) {
    asm volatile("s_waitcnt vmcnt(0)" ::: "memory");
    __syncthreads();
    if (threadIdx.x == 0) {
        unsigned* bar = b.bar;
        __builtin_amdgcn_s_waitcnt(0);
        unsigned nloc = b.st[0], nx = b.st[1];
        if (nloc == 0u) { xcd_barrier_complete(bar, b.x, nloc, nx); b.st[0] = nloc; b.st[1] = nx; }
        const unsigned old = xb_add(&bar[XB_XSUB(b.x)], 1u);
        const unsigned gen = old / nloc;
        if (old + 1u == (gen + 1u) * nloc) {
            __builtin_amdgcn_fence(__ATOMIC_RELEASE, "agent");
            asm volatile("s_waitcnt vmcnt(0)" ::: "memory");
            const unsigned og = xb_add(&bar[XB_TOP], 1u);
            const unsigned tg = og / nx;
            if (og + 1u == (tg + 1u) * nx) xb_add(&bar[XB_TOPGEN], 1u);
            else XB_SPIN(xb_ld(&bar[XB_TOPGEN]) == tg, bar);
            __builtin_amdgcn_fence(__ATOMIC_ACQUIRE, "agent");
            xb_add(&bar[XB_XGEN(b.x)], 1u);
            asm volatile("s_waitcnt vmcnt(0)" ::: "memory");
        } else {
            XB_SPIN(xb_ld(&bar[XB_XGEN(b.x)]) == gen, bar);
            __builtin_amdgcn_fence(__ATOMIC_ACQUIRE, "agent");
            asm volatile("s_waitcnt vmcnt(0)" ::: "memory");
        }
    }
    __syncthreads();
}

__device__ __forceinline__ float wave_sum(float v) {
#pragma unroll
    for (int o = 1; o < 64; o <<= 1) v += __shfl_xor(v, o);
    return v;
}
__device__ __forceinline__ float wave_max(float v) {
#pragma unroll
    for (int o = 1; o < 64; o <<= 1) v = fmaxf(v, __shfl_xor(v, o));
    return v;
}
__device__ __forceinline__ float dot4(const f32x4 a, const f32x4 b) { return (a[0] * b[0] + a[1] * b[1]) + (a[2] * b[2] + a[3] * b[3]); }
__device__ __forceinline__ v2u pack4(const f32x4 a) { v2u w; w.x = cvt_pk_bf16(a[0], a[1]); w.y = cvt_pk_bf16(a[2], a[3]); return w; }
__device__ __forceinline__ f32x4 unpack4(const v2u w) { f32x4 a; a[0] = __uint_as_float(w.x << 16); a[1] = __uint_as_float(w.x & 0xffff0000u); a[2] = __uint_as_float(w.y << 16); a[3] = __uint_as_float(w.y & 0xffff0000u); return a; }

struct Ctx { LAS unsigned char* lds; int tid, lane, wave, bx, G, gw, ngw; };

__device__ __forceinline__ void transpose_item(const float* W, int N, bf16* WT, int ldw, int coff, int k0, int n_src0, int n_dst0, LAS float* scr, int lane) {
#pragma unroll 8
    for (int i = 0; i < 32; ++i) { const int kk = 2 * i + (lane >> 5); scr[kk * 33 + (lane & 31)] = W[(size_t)(k0 + kk) * N + n_src0 + (lane & 31)]; }
    LDS_WAIT(); asm volatile("" ::: "memory");
    const int c = lane & 7;
#pragma unroll
    for (int j = 0; j < 4; ++j) { const int n = (lane >> 3) + 8 * j; const LAS float* s = scr + (8 * c) * 33 + n;
        v4u o; o.x = cvt_pk_bf16(s[0 * 33], s[1 * 33]); o.y = cvt_pk_bf16(s[2 * 33], s[3 * 33]); o.z = cvt_pk_bf16(s[4 * 33], s[5 * 33]); o.w = cvt_pk_bf16(s[6 * 33], s[7 * 33]);
        *(GAS v4u*)(WT + (size_t)(n_dst0 + n) * ldw + coff + k0 + 8 * c) = o; }
    LDS_WAIT(); asm volatile("" ::: "memory");
}
__device__ __forceinline__ int win_src_col(int vc0) {
    const int pn = vc0 >> 8, p = vc0 & 255;
    if (pn < 6) { const int g = pn % 3, base = pn < 3 ? 0 : 768, bj = p >> 7, hh = (p & 127) >> 5; return base + 256 * g + 64 * hh + 32 * bj; }
    if (pn >= 12 && pn < 18) { const int j = pn - 12, bj = p >> 7, x0 = p & 127; return (bj ? 3840 : 3072) + 128 * j + x0; }
    return vc0;
}
constexpr int IT_IN = 16 * 208, IT_CO = 12 * 32, IT_AO = 4 * 32, IT_O = 16 * 32, IT_UP = 16 * 128, IT_DN = 64 * 32, IT_G = 16 * 32, IT_PP = 4 * 32;
constexpr int IT_LAYER = IT_IN + IT_CO + IT_AO + IT_O + IT_UP + IT_DN + IT_G + IT_PP;

struct Args { const float* in[25]; float* out; unsigned char* ws; int ph_lo, ph_hi; };
typedef const __attribute__((address_space(4))) Args* KArgs;

__device__ __forceinline__ void prologue(const Ctx& C, KArgs ka) {
    unsigned char* ws = ka->ws;
    LAS float* scr = (LAS float*)(C.lds + RING_OFF + C.wave * 16384);
    for (int it = C.gw; it < DEPTH * IT_LAYER; it += C.ngw) {
        const int l = it / IT_LAYER; int r = it % IT_LAYER;
        bf16* Wl = (bf16*)(ws + WS_W + (size_t)l * W_LAYER);
        if (r < IT_IN) { const int kb = r / 208, nb = r % 208; transpose_item(ka->in[11] + (size_t)l * DM * NPROJ, NPROJ, Wl + W_IN / 2, DM, 0, 64 * kb, win_src_col(32 * nb), 32 * nb, scr, C.lane); continue; } r -= IT_IN;
        if (r < IT_CO) { const int kb = r / 32, nb = r % 32; transpose_item(ka->in[14] + (size_t)l * AW * DM, DM, Wl + W_CAT / 2, DM, 0, 64 * kb, 32 * nb, 32 * nb, scr, C.lane); continue; } r -= IT_CO;
        if (r < IT_AO) { const int kb = r / 32, nb = r % 32; transpose_item(ka->in[13] + (size_t)l * 256 * DM, DM, Wl + W_CAT / 2, DM, AW, 64 * kb, 32 * nb, 32 * nb, scr, C.lane); continue; } r -= IT_AO;
        if (r < IT_O) { const int kb = r / 32, nb = r % 32; transpose_item(ka->in[15] + (size_t)l * DM * DM, DM, Wl + W_O / 2, DM, 0, 64 * kb, 32 * nb, 32 * nb, scr, C.lane); continue; } r -= IT_O;
        if (r < IT_UP) { const int kb = r / 128, nb = r % 128; transpose_item(ka->in[18] + (size_t)l * DM * FF, FF, Wl + W_UP / 2, DM, 0, 64 * kb, 32 * nb, 32 * nb, scr, C.lane); continue; } r -= IT_UP;
        if (r < IT_DN) { const int kb = r / 32, nb = r % 32; transpose_item(ka->in[19] + (size_t)l * FF * DM, DM, Wl + W_DN / 2, FF, 0, 64 * kb, 32 * nb, 32 * nb, scr, C.lane); continue; } r -= IT_DN;
        if (r < IT_G) { const int kb = r / 32, nb = r % 32; transpose_item(ka->in[23] + (size_t)l * DM * DM, DM, Wl + W_G / 2, DM, 0, 64 * kb, 32 * nb, 32 * nb, scr, C.lane); continue; } r -= IT_G;
        { const int kb = r / 32, nb = r % 32; transpose_item(ka->in[24] + (size_t)l * PLE * DM, DM, Wl + W_PP / 2, PLE, 0, 64 * kb, 32 * nb, 32 * nb, scr, C.lane); }
    }
    const int gt = C.gw * 64 + C.lane, ngt = C.ngw * 64;
    { float* rope = (float*)(ws + WS_ROPE);
      for (int e = gt; e < 8193 * 32; e += ngt) { const int pos = e >> 5, d = e & 31;
          const float inv = (float)exp2(-(double)d * (13.287712379549449 / 32.0));
          const double ang = (double)((float)pos * inv), rev = ang * 0.15915494309189535, fr = rev - floor(rev);
          f32x2 cs; cs.x = __builtin_amdgcn_cosf((float)fr); cs.y = __builtin_amdgcn_sinf((float)fr);
          *(GAS f32x2*)(rope + 2 * (size_t)e) = cs; } }
    { for (int e = gt; e < DEPTH * MP * (PLE / 8); e += ngt) { const int l = e / (MP * 32), r2 = e % (MP * 32), row = r2 >> 5, c8 = (r2 & 31) * 8;
          const float* src = row < M ? ka->in[2] + ((size_t)l * M + row) * PLE + c8 : ka->in[3] + ((size_t)l * NS + (row - M)) * PLE + c8;
          const f32x4 x0 = *(const GAS f32x4*)src, x1 = *(const GAS f32x4*)(src + 4);
          *(GAS v4u*)((bf16*)(ws + WS_PLE + (size_t)l * PLE_LAYER) + (size_t)row * PLE + c8) = pg8::pack8(x0, x1); } }
    { for (int e = gt; e < MP * (DM / 4); e += ngt) { const int row = e >> 8, c4 = (e & 255) * 4;
          const float* src = row < M ? ka->in[0] + (size_t)row * DM + c4 : ka->in[1] + (size_t)(row - M) * DM + c4;
          *(GAS f32x4*)(ka->out + (size_t)row * DM + c4) = *(const GAS f32x4*)src; } }
    {
#pragma unroll
      for (int tix = 0; tix < 6; ++tix) { const int W = 128 << (2 * (tix >> 1)); const size_t n4 = (size_t)DEPTH * NS * W * 64;
          const size_t off = tix == 0 ? O_K128S : tix == 1 ? O_V128S : tix == 2 ? O_K512S : tix == 3 ? O_V512S : tix == 4 ? O_K2048S : O_V2048S;
          const GAS f32x4* src = (const GAS f32x4*)ka->in[4 + tix]; GAS f32x4* dst = (GAS f32x4*)(ka->out + off);
          for (size_t i = gt; i < n4; i += ngt) { const unsigned row = (unsigned)(i >> 6); if ((row & (W - 1)) != (unsigned)(W - 1)) dst[i] = src[i + 64]; } } }
}

template <int MODE> __device__ __forceinline__ void row_pass(const Ctx& C, float* h, const float* t1, const float* g1, const float* g2, bf16* xn, int nrows) {
    for (int m = C.gw; m < nrows; m += C.ngw) {
        GAS f32x4* hr = (GAS f32x4*)(h + (size_t)m * DM) + C.lane;
        f32x4 v[4];
#pragma unroll
        for (int j = 0; j < 4; ++j) v[j] = hr[64 * j];
        if (MODE == 1) {
            const GAS f32x4* tr = (const GAS f32x4*)(t1 + (size_t)m * DM) + C.lane; f32x4 t[4]; float s = 0.f;
#pragma unroll
            for (int j = 0; j < 4; ++j) { t[j] = tr[64 * j]; s += dot4(t[j], t[j]); }
            const float rstd = 1.0f / sqrtf(wave_sum(s) * (1.0f / DM) + RMS_EPS);
#pragma unroll
            for (int j = 0; j < 4; ++j) { const f32x4 gg = ((const GAS f32x4*)g1)[C.lane + 64 * j]; v[j] = v[j] + t[j] * rstd * gg; hr[64 * j] = v[j]; }
        }
        float s2 = 0.f;
#pragma unroll
        for (int j = 0; j < 4; ++j) s2 += dot4(v[j], v[j]);
        const float rstd2 = 1.0f / sqrtf(wave_sum(s2) * (1.0f / DM) + RMS_EPS);
        GAS v2u* o8 = (GAS v2u*)(xn + (size_t)m * DM) + C.lane;
#pragma unroll
        for (int j = 0; j < 4; ++j) { const f32x4 gg = ((const GAS f32x4*)g2)[C.lane + 64 * j]; o8[64 * j] = pack4(v[j] * rstd2 * gg); }
    }
}

__device__ __forceinline__ void attn_prompt(const Ctx& C, const bf16* Q, const bf16* K, const bf16* V, bf16* OG, float* ML) {
    const int lane = C.lane, r32 = lane & 31, h = lane >> 5, half = C.wave >> 2, w4 = C.wave & 3, i0 = 32 * w4;
    LAS unsigned char* vimg = C.lds + RING_OFF + half * 32768;
    const unsigned vbase = (unsigned)(size_t)vimg;
    const int i16 = lane & 15, tq = i16 >> 2, tp = i16 & 3, blk = (lane >> 4) & 1;
    for (int task = C.bx; task < 768; task += C.G) {
        const int b = task / 384, rem = task % 384, g = rem >> 7, rem2 = rem & 127, hp = rem2 >> 6, rn = rem2 & 63;
        const int dsh = 2 * g, nblk = 64 >> dsh, rr = rn >> (6 - dsh), n = rn & (nblk - 1);
        const int head = 4 * g + 2 * hp + half, sbase = n * 128;
        const size_t rowb = (size_t)b * SEQ;
        __syncthreads();
#pragma unroll
        for (int it = 0; it < 8; ++it) { const int c = it * 4 + w4; int si = sbase + 8 * c + (lane >> 3) - 128; si = si < 0 ? 0 : si;
            const bf16* src = V + (rowb + ((size_t)si << dsh) + rr) * AW + head * 64 + (lane & 7) * 8;
            __builtin_amdgcn_global_load_lds((const unsigned*)src, (LAS unsigned*)(vimg + c * 1024), 16, 0, 0); }
        const size_t qrow = rowb + ((size_t)(sbase + i0 + r32) << dsh) + rr;
        bf16x8 qf[4];
        { const GAS bf16x8* qp = (const GAS bf16x8*)(Q + qrow * AW + head * 64 + 8 * h);
#pragma unroll
          for (int s = 0; s < 4; ++s) qf[s] = qp[2 * s]; }
        f32x16 st[5];
#pragma unroll
        for (int kt = 0; kt < 5; ++kt) { int si = sbase + i0 - 128 + 32 * kt + r32; si = si < 0 ? 0 : si;
            const GAS bf16x8* kp = (const GAS bf16x8*)(K + (rowb + ((size_t)si << dsh) + rr) * AW + head * 64 + 8 * h);
            bf16x8 kf[4];
#pragma unroll
            for (int s = 0; s < 4; ++s) kf[s] = kp[2 * s];
            f32x16 acc;
#pragma unroll
            for (int i = 0; i < 16; ++i) acc[i] = 0.f;
#pragma unroll
            for (int s = 0; s < 4; ++s) acc = MFMA32(kf[s], qf[s], acc);
            st[kt] = acc; }
        float mx = -3.0e38f;
#pragma unroll
        for (int kt = 0; kt < 5; ++kt)
#pragma unroll
            for (int i = 0; i < 16; ++i) { const int kk = 32 * kt + crow(i, h); const bool ok = (kk >= r32) && (kk <= r32 + 128) && (sbase + i0 - 128 + kk >= 0);
                const float sv = ok ? st[kt][i] : -3.0e38f; st[kt][i] = sv; mx = fmaxf(mx, sv); }
        mx = fmaxf(mx, __shfl_xor(mx, 32));
        float l = 0.f;
#pragma unroll
        for (int kt = 0; kt < 5; ++kt)
#pragma unroll
            for (int i = 0; i < 16; ++i) { const float p = __builtin_amdgcn_exp2f(st[kt][i] - mx); st[kt][i] = p; l += p; }
        l += __shfl_xor(l, 32);
        bf16x8 pb[5][2];
#pragma unroll
        for (int kt = 0; kt < 5; ++kt)
#pragma unroll
            for (int s2 = 0; s2 < 2; ++s2) { v4u w; w.x = cvt_pk_bf16(st[kt][8 * s2 + 0], st[kt][8 * s2 + 1]); w.y = cvt_pk_bf16(st[kt][8 * s2 + 2], st[kt][8 * s2 + 3]);
                w.z = cvt_pk_bf16(st[kt][8 * s2 + 4], st[kt][8 * s2 + 5]); w.w = cvt_pk_bf16(st[kt][8 * s2 + 6], st[kt][8 * s2 + 7]); pb[kt][s2] = __builtin_bit_cast(bf16x8, w); }
        VM_WAIT(); __syncthreads();
        f32x16 ot[2];
#pragma unroll
        for (int i = 0; i < 16; ++i) { ot[0][i] = 0.f; ot[1][i] = 0.f; }
        {   const unsigned tb = vbase + (unsigned)((i0 + 4 * h + tq) * 128 + 32 * blk + 8 * tp);
#define TR_STEP(kt, s2) do { s16x4 l0, h0, l1, h1; \
                asm volatile("ds_read_b64_tr_b16 %0, %4 offset:%5\n\tds_read_b64_tr_b16 %1, %4 offset:%6\n\tds_read_b64_tr_b16 %2, %4 offset:%7\n\tds_read_b64_tr_b16 %3, %4 offset:%8\n\ts_waitcnt lgkmcnt(0)" \
                    : "=&v"(l0), "=&v"(h0), "=&v"(l1), "=&v"(h1) : "v"(tb), "n"((32 * (kt) + 16 * (s2)) * 128), "n"((32 * (kt) + 16 * (s2) + 8) * 128), "n"((32 * (kt) + 16 * (s2)) * 128 + 64), "n"((32 * (kt) + 16 * (s2) + 8) * 128 + 64) : "memory"); \
                ot[0] = MFMA32(__builtin_shufflevector(l0, h0, 0, 1, 2, 3, 4, 5, 6, 7), pb[kt][s2], ot[0]); \
                ot[1] = MFMA32(__builtin_shufflevector(l1, h1, 0, 1, 2, 3, 4, 5, 6, 7), pb[kt][s2], ot[1]); } while (0)
            TR_STEP(0, 0); TR_STEP(0, 1); TR_STEP(1, 0); TR_STEP(1, 1); TR_STEP(2, 0); TR_STEP(2, 1); TR_STEP(3, 0); TR_STEP(3, 1); TR_STEP(4, 0); TR_STEP(4, 1);
#undef TR_STEP
        }
        const float inv = 1.0f / l;
        bf16* op = OG + qrow * AW + head * 64;
#pragma unroll
        for (int dt = 0; dt < 2; ++dt)
#pragma unroll
            for (int gq = 0; gq < 4; ++gq) { v2u w; w.x = cvt_pk_bf16(ot[dt][4 * gq] * inv, ot[dt][4 * gq + 1] * inv); w.y = cvt_pk_bf16(ot[dt][4 * gq + 2] * inv, ot[dt][4 * gq + 3] * inv);
                *(GAS v2u*)(op + 32 * dt + 8 * gq + 4 * h) = w; }
        if (h == 0) { f32x2 ml; ml.x = mx; ml.y = l; *(GAS f32x2*)(ML + (qrow * 12 + head) * 2) = ml; }
    }
}

__device__ __forceinline__ void merge_conv_pass(const Ctx& C, const bf16* CB, const bf16* U, const bf16* OG, const float* ML, const float* convw, bf16* ACAT) {
    const int lane = C.lane;
    for (int m = C.gw; m < M; m += C.ngw) {
        const int t = m & (SEQ - 1);
#pragma unroll
        for (int j = 0; j < 3; ++j) { const int q = lane + 64 * j;
            const f32x4 cb = unpack4(*(const GAS v2u*)(CB + (size_t)m * AW + 4 * q)), u0 = unpack4(*(const GAS v2u*)(U + (size_t)m * AW + 4 * q));
            f32x4 u1 = {0.f, 0.f, 0.f, 0.f}, u2 = {0.f, 0.f, 0.f, 0.f};
            if (t >= 1) u1 = unpack4(*(const GAS v2u*)(U + (size_t)(m - 1) * AW + 4 * q));
            if (t >= 2) u2 = unpack4(*(const GAS v2u*)(U + (size_t)(m - 2) * AW + 4 * q));
            const f32x4 w0 = *(const GAS f32x4*)(convw + 4 * q), w1 = *(const GAS f32x4*)(convw + AW + 4 * q), w2 = *(const GAS f32x4*)(convw + 2 * AW + 4 * q);
            *(GAS v2u*)(ACAT + (size_t)m * DM + 4 * q) = pack4(cb * (w0 * u2 + w1 * u1 + w2 * u0)); }
        const int hh = lane >> 4, d4 = 4 * (lane & 15);
        f32x2 ml[3]; f32x4 o[3];
#pragma unroll
        for (int g = 0; g < 3; ++g) { ml[g] = *(const GAS f32x2*)(ML + ((size_t)m * 12 + 4 * g + hh) * 2); o[g] = unpack4(*(const GAS v2u*)(OG + (size_t)m * AW + 256 * g + 64 * hh + d4)); }
        const float mx = fmaxf(ml[0].x, fmaxf(ml[1].x, ml[2].x));
        const float e0 = __builtin_amdgcn_exp2f(ml[0].x - mx) * ml[0].y, e1 = __builtin_amdgcn_exp2f(ml[1].x - mx) * ml[1].y, e2 = __builtin_amdgcn_exp2f(ml[2].x - mx) * ml[2].y;
        const float inv = 1.0f / (e0 + e1 + e2);
        *(GAS v2u*)(ACAT + (size_t)m * DM + AW + 64 * hh + d4) = pack4((o[0] * e0 + o[1] * e1 + o[2] * e2) * inv);
    }
}

__device__ __forceinline__ f32x16 skinny(const bf16* A, int lda, const bf16* Bt, int ldb, int K, int n0, int lane) {
    const int r = lane & 31, h = lane >> 5;
    const GAS bf16x8* ap = (const GAS bf16x8*)(A + (size_t)r * lda + 8 * h);
    const GAS bf16x8* bp = (const GAS bf16x8*)(Bt + (size_t)(n0 + r) * ldb + 8 * h);
    f32x16 acc;
#pragma unroll
    for (int i = 0; i < 16; ++i) acc[i] = 0.f;
    for (int s = 0; s < K / 16; s += 4) {
        bf16x8 a[4], b[4];
#pragma unroll
        for (int u = 0; u < 4; ++u) { a[u] = ap[2 * (s + u)]; b[u] = bp[2 * (s + u)]; }
#pragma unroll
        for (int u = 0; u < 4; ++u) acc = MFMA32(a[u], b[u], acc);
    }
    return acc;
}
#ifndef SAMPLE_ON
#define SAMPLE_ON 1
#endif
#define SAMPLE_TASKS(t, T, off) for (int t = C.wave * 128 + (C.bx - (off)); SAMPLE_ON && C.bx >= (off) && C.bx < (off) + 128 && t < (T); t += 1024)

__device__ __forceinline__ void sample_attn(const Ctx& C, int l, const float* PS, const float* rope, KArgs ka, bf16* ACAT) {
    if (C.bx >= 128) return;
    const int lane = C.lane, b = C.bx >> 2, hh = C.bx & 3;
    LAS float* sm = (LAS float*)(C.lds + RING_OFF);
    const float* ps = PS + (size_t)b * NPROJ;
    if (C.wave < 3) {
        const int g = C.wave, dsh = 2 * g, W = 128 << dsh, d = lane, dl = d & 31, bj = d >> 5;
        const int vq = 256 * g + 128 * bj + 32 * hh + dl;
        const float xq = ps[vq], xk = ps[768 + vq], xv = ps[1536 + 256 * g + 64 * hh + d];
        const f32x2 cs = *(const GAS f32x2*)(rope + ((size_t)SEQ * 32 + dl) * 2);
        const float pq = __shfl_xor(xq, 32), pk = __shfl_xor(xk, 32);
        const float q = (bj ? (xq * cs.x + pq * cs.y) : (xq * cs.x - pq * cs.y)) * pg8::QSCALE;
        const float kn = bj ? (xk * cs.x + pk * cs.y) : (xk * cs.x - pk * cs.y);
        LAS float* wq = sm + C.wave * 256; LAS float* wp = wq + 64;
        wq[lane] = q; LDS_WAIT(); asm volatile("" ::: "memory");
        const size_t cbase = ((size_t)(l * NS + b) * W) * 256 + hh * 64;
        const float* ck = ka->in[4 + 2 * g] + cbase; const float* cv = ka->in[5 + 2 * g] + cbase;
        float s1 = 0.f, s2 = 0.f;
        { const GAS f32x4* r1 = (const GAS f32x4*)(ck + ((size_t)(W - ((1 + lane) << dsh))) * 256); const GAS f32x4* r2 = (const GAS f32x4*)(ck + ((size_t)(W - ((65 + lane) << dsh))) * 256);
#pragma unroll
          for (int c4 = 0; c4 < 16; ++c4) { const f32x4 qv = *(const LAS f32x4*)(wq + 4 * c4); s1 += dot4(r1[c4], qv); s2 += dot4(r2[c4], qv); } }
        const float s0 = wave_sum(q * kn);
        const float mx = fmaxf(s0, wave_max(fmaxf(s1, s2)));
        const float p0 = __builtin_amdgcn_exp2f(s0 - mx), p1 = __builtin_amdgcn_exp2f(s1 - mx), p2 = __builtin_amdgcn_exp2f(s2 - mx);
        const float lsum = p0 + wave_sum(p1 + p2);
        wp[1 + lane] = p1; wp[65 + lane] = p2; LDS_WAIT(); asm volatile("" ::: "memory");
        float o = p0 * xv;
#pragma unroll 8
        for (int j = 1; j <= 128; ++j) o += wp[j] * cv[((size_t)(W - (j << dsh))) * 256 + d];
        LAS float* res = sm + 1024 + g * 80;
        if (lane == 0) { res[0] = mx; res[1] = lsum; }
        res[2 + lane] = o;
        const size_t orow = ((size_t)(l * NS + b) * W + (W - 1)) * 256 + hh * 64 + d;
        float* const o_ = ka->out; o_[(g == 0 ? O_K128S : (g == 1 ? O_K512S : O_K2048S)) + orow] = kn; o_[(g == 0 ? O_V128S : (g == 1 ? O_V512S : O_V2048S)) + orow] = xv;
    } else if (C.wave == 3 && hh == 0) {
#pragma unroll
        for (int i = 0; i < 12; ++i) { const int c = lane + 64 * i, j = c >> 7, x = c & 127;
            const float cb = ps[2304 + c], cc = ps[256 * (12 + j) + x], ch = ps[256 * (12 + j) + 128 + x], u = cc * ch;
            const float* const state = ka->in[10]; const float* const convw = ka->in[12] + (size_t)l * 3 * AW; float* const oconv = ka->out + O_CONVS;
            const float st0 = state[((size_t)(l * NS + b) * 2 + 0) * AW + c], st1 = state[((size_t)(l * NS + b) * 2 + 1) * AW + c];
            const float w0 = convw[c], w1 = convw[AW + c], w2 = convw[2 * AW + c];
            ACAT[(size_t)(M + b) * DM + c] = (bf16)(cvt_pk_bf16(cb * (w0 * st0 + w1 * st1 + w2 * u), 0.f) & 0xffffu);
            oconv[((size_t)(l * NS + b) * 2 + 0) * AW + c] = st1; oconv[((size_t)(l * NS + b) * 2 + 1) * AW + c] = u; }
    }
    LDS_WAIT(); __syncthreads();
    if (C.wave == 0) {
        const LAS float* r0 = sm + 1024; const LAS float* r1 = r0 + 80; const LAS float* r2 = r0 + 160;
        const float mx = fmaxf(r0[0], fmaxf(r1[0], r2[0]));
        const float e0 = __builtin_amdgcn_exp2f(r0[0] - mx), e1 = __builtin_amdgcn_exp2f(r1[0] - mx), e2 = __builtin_amdgcn_exp2f(r2[0] - mx);
        const float num = e0 * r0[2 + lane] + e1 * r1[2 + lane] + e2 * r2[2 + lane], den = e0 * r0[1] + e1 * r1[1] + e2 * r2[1];
        ACAT[(size_t)(M + b) * DM + AW + 64 * hh + lane] = (bf16)(cvt_pk_bf16(num / den, 0.f) & 0xffffu);
    }
    __syncthreads();
}

__device__ __forceinline__ KArgs get_args() { KArgs p = (KArgs)__builtin_amdgcn_kernarg_segment_ptr(); asm volatile("" : "+s"(p)); return p; }
__global__ void __launch_bounds__(NWAVES * 64, 2) mk_fwd(Args args) {
    extern __shared__ __attribute__((aligned(16))) unsigned char lds_raw[];
    Ctx C;
    C.lds = (LAS unsigned char*)lds_raw;
    C.tid = threadIdx.x; C.lane = C.tid & 63; C.wave = __builtin_amdgcn_readfirstlane(C.tid >> 6);
    C.G = gridDim.x; C.bx = blockIdx.x;
    { const int vcu = (C.G % 8 == 0) ? (C.bx % 8) * (C.G / 8) + C.bx / 8 : C.bx; C.gw = vcu * NWAVES + C.wave; C.ngw = C.G * NWAVES; }
    volatile LAS unsigned* MISC = (volatile LAS unsigned*)(C.lds + MISC_OFF);
    gu32* ctl = (gu32*)(args.ws + WS_CTL);
    for (int u = C.tid; u < (LDS_BYTES - LDSCTL_OFF) / 4; u += NWAVES * 64) ((LAS unsigned*)(C.lds + LDSCTL_OFF))[u] = 0u;
    __syncthreads();
    const int lo = args.ph_lo, hi = args.ph_hi;
    XcdBarrier bar; bar.bar = (unsigned*)(ctl + CW_BAR); bar.x = 0; bar.st = nullptr;
    if (hi - lo > 1) bar = xcd_barrier_post((unsigned*)(ctl + CW_BAR), MISC + 8);
#define IN(k) (lo <= (k) && (k) < hi)
#define SEAM(k) do { if (IN(k) && IN((k) + 1)) { XcdBarrier b2 = bar; asm volatile("" : "+s"(b2.bar), "+s"(b2.x)); xcd_barrier(b2); } } while (0)

#define KA (get_args())
#define ws (KA->ws)
#define out (KA->out)
#define p_XN ((bf16*)(ws + WS_XN))
#define p_Qb ((bf16*)(ws + WS_Q))
#define p_Kb ((bf16*)(ws + WS_K))
#define p_Vb ((bf16*)(ws + WS_V))
#define p_CBb ((bf16*)(ws + WS_CB))
#define p_Ub ((bf16*)(ws + WS_U))
#define p_OGb ((bf16*)(ws + WS_OG))
#define p_SGA ((bf16*)(ws + WS_SGA))
#define p_SGB ((bf16*)(ws + WS_SGB))
#define p_ML ((float*)(ws + WS_ML))
#define p_ACAT ((bf16*)(ws + WS_ACAT))
#define p_UG ((bf16*)(ws + WS_UG))
#define p_Fb ((bf16*)(ws + WS_F))
#define p_T1 ((float*)(ws + WS_T1))
#define p_PS ((float*)(ws + WS_PS))
#define p_rope ((const float*)(ws + WS_ROPE))
    LAS unsigned char* const ring = C.lds + RING_OFF;

    if (PH_ON(15) && IN(0)) { prologue(C, KA); SEAM(0); }

    for (int l = 0; l < DEPTH; ++l) {
        const int pb = 1 + l * NPH_LAYER;
#define Wl ((const bf16*)(ws + WS_W + (size_t)l * W_LAYER))
#define WIN_T (Wl + W_IN / 2)
#define WCAT_T (Wl + W_CAT / 2)
#define WO_T (Wl + W_O / 2)
#define WUP_T (Wl + W_UP / 2)
#define WDN_T (Wl + W_DN / 2)
#define WG_T (Wl + W_G / 2)
#define WPP_T (Wl + W_PP / 2)
#define PLEl ((const bf16*)(ws + WS_PLE + (size_t)l * PLE_LAYER))
#define g_pre_mix (KA->in[16] + l * DM)
#define g_post_mix (KA->in[17] + l * DM)
#define g_pre_mlp (KA->in[20] + l * DM)
#define g_post_mlp (KA->in[21] + l * DM)
#define g_ple (KA->in[22] + l * DM)

        if (PH_ON(0) && IN(pb + 0)) { { Ctx L = C; asm volatile("" : "+v"(L.lane)); row_pass<0>(L, out, nullptr, nullptr, g_pre_mix, p_XN, MP); } SEAM(pb + 0); }

        if (PH_ON(1) && IN(pb + 1)) {
            pg8::Gemm g{p_XN, WIN_T, M, NPROJ, DM, DM, DM}; pg8::StaticOrder S; S.init(M, NPROJ, C.G, C.bx);
            const pg8::EpiInProj E{ws, out, l};
            pg8::gemm_phase<pg8::EpiInProj, pg8::StaticOrder, true, true>(ring, g, S, E);
            { int sl = C.lane; asm volatile("" : "+v"(sl)); SAMPLE_TASKS(t, NPROJ / 32, 128) { const f32x16 acc = skinny(p_XN + (size_t)M * DM, DM, WIN_T, DM, DM, 32 * t, sl);
#pragma unroll
                for (int i = 0; i < 16; ++i) p_PS[(size_t)crow(i, sl >> 5) * NPROJ + 32 * t + (sl & 31)] = acc[i]; } }
            SEAM(pb + 1);
        }

        if (PH_ON(2) && IN(pb + 2)) {
            Ctx L = C; asm volatile("" : "+v"(L.lane));
            attn_prompt(L, p_Qb, p_Kb, p_Vb, p_OGb, p_ML);
            __syncthreads();
            sample_attn(L, l, p_PS, p_rope, KA, p_ACAT);
            SEAM(pb + 2);
        }

        if (PH_ON(3) && IN(pb + 3)) { { Ctx L = C; asm volatile("" : "+v"(L.lane)); merge_conv_pass(L, p_CBb, p_Ub, p_OGb, p_ML, KA->in[12] + (size_t)l * 3 * AW, p_ACAT); } SEAM(pb + 3); }

        if (PH_ON(4) && IN(pb + 4)) {
            pg8::Gemm g{p_ACAT + AW, WCAT_T + AW, M, DM, 256, DM, DM}; pg8::StaticOrder S; S.init(M, DM, C.G, C.bx);
            pg8::EpiF32 E{p_T1, DM};
            pg8::gemm_phase<pg8::EpiF32, pg8::StaticOrder, false, true>(ring, g, S, E);
            SEAM(pb + 4);
        }

        if (PH_ON(5) && IN(pb + 5)) {
            pg8::Gemm g{p_ACAT, WCAT_T, M, DM, AW, DM, DM}; pg8::StaticOrder S; S.init(M, DM, C.G, C.bx);
            pg8::EpiGateMix E{p_T1, p_SGA, p_SGB, p_UG};
            pg8::gemm_phase<pg8::EpiGateMix, pg8::StaticOrder, false, true>(ring, g, S, E);
            { int sl = C.lane; asm volatile("" : "+v"(sl)); SAMPLE_TASKS(t, DM / 32, 0) { const f32x16 ac = skinny(p_ACAT + (size_t)M * DM, DM, WCAT_T, DM, AW, 32 * t, sl), aa = skinny(p_ACAT + (size_t)M * DM + AW, DM, WCAT_T + AW, DM, 256, 32 * t, sl);
#pragma unroll
                for (int i = 0; i < 16; ++i) { const int tok = crow(i, sl >> 5), n = 32 * t + (sl & 31);
                    const float ga = sigmoidf_fast(p_PS[(size_t)tok * NPROJ + 4608 + n]), gb = sigmoidf_fast(p_PS[(size_t)tok * NPROJ + 5632 + n]);
                    p_UG[(size_t)(M + tok) * DM + n] = (bf16)(cvt_pk_bf16(ga * aa[i] + gb * ac[i], 0.f) & 0xffffu); } } }
            SEAM(pb + 5);
        }

        if (PH_ON(6) && IN(pb + 6)) {
            pg8::Gemm g{p_UG, WO_T, M, DM, DM, DM, DM}; pg8::StaticOrder S; S.init(M, DM, C.G, C.bx);
            pg8::EpiF32 E{p_T1, DM};
            pg8::gemm_phase<pg8::EpiF32, pg8::StaticOrder, false, true>(ring, g, S, E);
            { int sl = C.lane; asm volatile("" : "+v"(sl)); SAMPLE_TASKS(t, DM / 32, 0) { const f32x16 acc = skinny(p_UG + (size_t)M * DM, DM, WO_T, DM, DM, 32 * t, sl);
#pragma unroll
                for (int i = 0; i < 16; ++i) p_T1[(size_t)(M + crow(i, sl >> 5)) * DM + 32 * t + (sl & 31)] = acc[i]; } }
            SEAM(pb + 6);
        }

        if (PH_ON(7) && IN(pb + 7)) { { Ctx L = C; asm volatile("" : "+v"(L.lane)); row_pass<1>(L, out, p_T1, g_post_mix, g_pre_mlp, p_XN, MP); } SEAM(pb + 7); }

        if (PH_ON(8) && IN(pb + 8)) {
            pg8::Gemm g{p_XN, WUP_T, M, FF, DM, DM, DM}; pg8::StaticOrder S; S.init(M, FF, C.G, C.bx);
            pg8::EpiRelu2 E{p_Fb, FF};
            pg8::gemm_phase<pg8::EpiRelu2, pg8::StaticOrder, true, true>(ring, g, S, E);
            { int sl = C.lane; asm volatile("" : "+v"(sl)); SAMPLE_TASKS(t, FF / 32, 0) { const f32x16 acc = skinny(p_XN + (size_t)M * DM, DM, WUP_T, DM, DM, 32 * t, sl);
#pragma unroll
                for (int i = 0; i < 16; ++i) { const float r = fmaxf(acc[i], 0.f); p_Fb[(size_t)(M + crow(i, sl >> 5)) * FF + 32 * t + (sl & 31)] = (bf16)(cvt_pk_bf16(r * r, 0.f) & 0xffffu); } } }
            SEAM(pb + 8);
        }

        if (PH_ON(9) && IN(pb + 9)) {
            pg8::Gemm g{p_Fb, WDN_T, M, DM, FF, FF, FF}; pg8::StaticOrder S; S.init(M, DM, C.G, C.bx);
            pg8::EpiF32 E{p_T1, DM};
            pg8::gemm_phase<pg8::EpiF32, pg8::StaticOrder, false, true>(ring, g, S, E);
            { int sl = C.lane; asm volatile("" : "+v"(sl)); SAMPLE_TASKS(t, DM / 32, 0) { const f32x16 acc = skinny(p_Fb + (size_t)M * FF, FF, WDN_T, FF, FF, 32 * t, sl);
#pragma unroll
                for (int i = 0; i < 16; ++i) p_T1[(size_t)(M + crow(i, sl >> 5)) * DM + 32 * t + (sl & 31)] = acc[i]; } }
            SEAM(pb + 9);
        }

        if (PH_ON(10) && IN(pb + 10)) { { Ctx L = C; asm volatile("" : "+v"(L.lane)); row_pass<1>(L, out, p_T1, g_post_mlp, g_ple, p_XN, MP); } SEAM(pb + 10); }

        if (PH_ON(11) && IN(pb + 11)) {
            pg8::Gemm g{PLEl, WPP_T, M, DM, PLE, PLE, PLE}; pg8::StaticOrder S; S.init(M, DM, C.G, C.bx);
            pg8::EpiF32 E{p_T1, DM};
            pg8::gemm_phase<pg8::EpiF32, pg8::StaticOrder, false, true>(ring, g, S, E);
            SEAM(pb + 11);
        }

        if (PH_ON(12) && IN(pb + 12)) {
            pg8::Gemm g{p_XN, WG_T, M, DM, DM, DM, DM}; pg8::StaticOrder S; S.init(M, DM, C.G, C.bx);
            pg8::EpiPleGate E{out, p_T1};
            pg8::gemm_phase<pg8::EpiPleGate, pg8::StaticOrder, false, true>(ring, g, S, E);
            { int sl = C.lane; asm volatile("" : "+v"(sl)); SAMPLE_TASKS(t, DM / 32, 0) { const f32x16 ag = skinny(p_XN + (size_t)M * DM, DM, WG_T, DM, DM, 32 * t, sl), ap = skinny(PLEl + (size_t)M * PLE, PLE, WPP_T, PLE, PLE, 32 * t, sl);
#pragma unroll
                for (int i = 0; i < 16; ++i) { float* hp = out + (size_t)(M + crow(i, sl >> 5)) * DM + 32 * t + (sl & 31); *hp = *hp + sigmoidf_fast(ag[i]) * ap[i]; } } }
            SEAM(pb + 12);
        }
    }
#undef IN
#undef SEAM
}


#undef KA
#undef ws
#undef out
#undef p_XN
#undef p_Qb
#undef p_Kb
#undef p_Vb
#undef p_CBb
#undef p_Ub
#undef p_OGb
#undef p_SGA
#undef p_SGB
#undef p_ML
#undef p_ACAT
#undef p_UG
#undef p_Fb
#undef p_T1
#undef p_PS
#undef p_rope
#undef Wl
#undef WIN_T
#undef WCAT_T
#undef WO_T
#undef WUP_T
#undef WDN_T
#undef WG_T
#undef WPP_T
#undef PLEl
#undef g_pre_mix
#undef g_post_mix
#undef g_pre_mlp
#undef g_post_mlp
#undef g_ple
extern "C" void kernel_launch(void* const* d_in, const int* in_sizes, int n_in, void* d_out, int out_size, void* d_ws, size_t ws_size, hipStream_t stream) {
    static int grid = 0;
    if (grid == 0) {
        if (n_in != 25 || in_sizes[0] != M * DM || (size_t)out_size != O_END || ws_size < WS_END) {
            fprintf(stderr, "kernel_launch: unexpected shapes: n_in %d in0 %d out %d ws %zu (need %zu); nothing launched\n", n_in, n_in > 0 ? in_sizes[0] : -1, out_size, ws_size, (size_t)WS_END); grid = -1; return; }
        int dev = 0, cus = 0;
        if (hipGetDevice(&dev) != hipSuccess || hipDeviceGetAttribute(&cus, hipDeviceAttributeMultiprocessorCount, dev) != hipSuccess) { fprintf(stderr, "kernel_launch: device query failed\n"); grid = -1; return; }
        if (hipFuncSetAttribute((const void*)mk_fwd, hipFuncAttributeMaxDynamicSharedMemorySize, LDS_BYTES) != hipSuccess) { fprintf(stderr, "kernel_launch: hipFuncSetAttribute failed\n"); grid = -1; return; }
        int per_cu = 0;
        if (hipOccupancyMaxActiveBlocksPerMultiprocessor(&per_cu, (const void*)mk_fwd, NWAVES * 64, LDS_BYTES) != hipSuccess || per_cu < 1) fprintf(stderr, "kernel_launch: note: occupancy query says %d\n", per_cu);
        (void)hipGetLastError();
        grid = cus;
    }
    if (grid < 0) return;
    if (hipMemsetAsync((char*)d_ws + WS_CTL, 0, CTL_ZERO_BYTES, stream) != hipSuccess) { fprintf(stderr, "kernel_launch: memset failed\n"); return; }
    Args a{};
    for (int i = 0; i < 25; ++i) a.in[i] = (const float*)d_in[i];
    a.out = (float*)d_out; a.ws = (unsigned char*)d_ws;
#if MK_ONE_LAUNCH
    a.ph_lo = 0; a.ph_hi = NPHASES;
    hipLaunchKernelGGL(mk_fwd, dim3(grid), dim3(NWAVES * 64), LDS_BYTES, stream, a);
#else
    for (int k = 0; k < NPHASES; ++k) { a.ph_lo = k; a.ph_hi = k + 1; hipLaunchKernelGGL(mk_fwd, dim3(grid), dim3(NWAVES * 64), LDS_BYTES, stream, a); }
#endif
    const hipError_t le = hipPeekAtLastError();
    if (le != hipSuccess) fprintf(stderr, "kernel_launch: launch failed: %s\n", hipGetErrorName(le));
}
```
